# Optimizing an MI355X kernel written in HIP

```python
import jax, jax.numpy as jnp
from jax import lax
import numpy as np

D_MODEL = 1024
BATCH = 8
SEQ = 2048
DEPTH = 4
DEC_BATCH = 128
DEC_SEQ = 8
PAST_LEN = 16384
PAGE_SIZE = 128

N_MIXERS = 4
D_FF = 2816
FFN_RES = 0.5
CHUNK = 128
A_WIDTH = D_MODEL
A_GROUPS = 4
B_WIDTH = 3
C_WIDTH = 31
POOL_WINDOWS = (2, 4, 8, 16)
POOL_GROUPS = len(POOL_WINDOWS)
POOL_GROUP_DIM = D_MODEL // POOL_GROUPS
POOL_BUF = max(POOL_WINDOWS) - 1
ALPHA = (2 * DEPTH) ** 0.25
BETA = (8 * DEPTH) ** -0.25
LN_EPS = 1e-5

kernel_name = "hybrid_gmlp_conv_pool_deepnorm_step"


def layer_norm(x, g, b):
    xf = x.astype(jnp.float32)
    mu = jnp.mean(xf, axis=-1, keepdims=True)
    var = jnp.mean(jnp.square(xf - mu), axis=-1, keepdims=True)
    y = (xf - mu) * lax.rsqrt(var + LN_EPS)
    return (y * g.astype(jnp.float32) + b.astype(jnp.float32)).astype(x.dtype)


def swiglu(h, w_in, w_out):
    g, u = jnp.split(h @ w_in, 2, axis=-1)
    return (jax.nn.silu(g) * u) @ w_out


def causal_dw_conv(xx, w):
    channels = w.shape[1]
    return lax.conv_general_dilated(
        xx, w[:, None, :].astype(xx.dtype), window_strides=(1,), padding='VALID',
        dimension_numbers=('NWC', 'WIO', 'NWC'), feature_group_count=channels)


def mixer_chunk_mlp(h, w_in, b_in, ln_g, ln_b, w_s, b_s, w_out):
    bn, t_len, _ = h.shape
    z = jax.nn.gelu(h @ w_in + b_in)
    u, v = jnp.split(z, 2, axis=-1)
    v = layer_norm(v, ln_g, ln_b)
    n_chunks = -(-t_len // CHUNK)
    pad = n_chunks * CHUNK - t_len
    vp = jnp.pad(v, ((0, 0), (0, pad), (0, 0))).reshape(
        bn, n_chunks, CHUNK, A_GROUPS, A_WIDTH // A_GROUPS)
    causal = jnp.tril(jnp.ones((CHUNK, CHUNK), dtype=bool))
    w_m = jnp.where(causal[None], w_s, 0)
    s = jnp.einsum('gts,bnsgc->bntgc', w_m, vp) + b_s.T[None, None, :, :, None]
    s = s.reshape(bn, n_chunks * CHUNK, A_WIDTH)[:, :t_len]
    y = (u * s) @ w_out
    last = ((t_len - 1) // CHUNK) * CHUNK
    return y, v[:, last:]


def mixer_short_conv(h, buf, w_in, conv_w, w_out):
    bg, cg, xin = jnp.split(h @ w_in, 3, axis=-1)
    xx = jnp.concatenate([buf, cg * xin], axis=1)
    y = bg * causal_dw_conv(xx, conv_w)
    return y @ w_out, xx[:, -(B_WIDTH - 1):]


def mixer_conformer_conv(h, buf, w_pw1, b_pw1, dw, b_dw, ln_g, ln_b, w_pw2, b_pw2):
    a, g = jnp.split(h @ w_pw1 + b_pw1, 2, axis=-1)
    glu = a * jax.nn.sigmoid(g)
    xx = jnp.concatenate([buf, glu], axis=1)
    z = causal_dw_conv(xx, dw) + b_dw
    z = jax.nn.silu(layer_norm(z, ln_g, ln_b))
    return z @ w_pw2 + b_pw2, xx[:, -(C_WIDTH - 1):]


def mixer_pool(h, buf, start_pos, w_grp, b_grp, scale):
    bn, t_len, _ = h.shape
    p_len = buf.shape[1]
    xx = jnp.concatenate([buf, h], axis=1)
    cs = jnp.cumsum(xx.astype(jnp.float32), axis=1)
    pos = start_pos + jnp.arange(t_len)
    hf = h.astype(jnp.float32)
    ds = []
    for gi, w in enumerate(POOL_WINDOWS):
        sl = slice(gi * POOL_GROUP_DIM, (gi + 1) * POOL_GROUP_DIM)
        csg = cs[..., sl]
        hi = csg[:, p_len:]
        lo = jnp.pad(csg, ((0, 0), (w, 0), (0, 0)))[:, p_len:p_len + t_len]
        count = jnp.minimum(pos + 1, w).astype(jnp.float32)[None, :, None]
        ds.append((hi - lo) / count - hf[..., sl])
    d = jnp.stack(ds, axis=2).astype(h.dtype)
    y = jnp.einsum('btgc,gce->btge', d, w_grp) + b_grp
    return y.reshape(bn, t_len, D_MODEL) * scale, xx[:, -POOL_BUF:]


def run_trunk(x, c, buf3, buf31, bufpool, start_pos, shared, a_p, b_p, c_p, d_p):
    ada_w, ada_b, ln_g, ln_b, ffn_w_in, ffn_w_out = shared
    bn = x.shape[0]
    new_v = new3 = new31 = newpool = None
    for i in range(DEPTH):
        mod = (jax.nn.silu(c) @ ada_w[i] + ada_b[i]).reshape(bn, 3, 3, D_MODEL)

        def modulate(h, s):
            return h * (1 + mod[:, s, 1][:, None, :]) + mod[:, s, 0][:, None, :]

        def gate(y, s):
            return (1 + mod[:, s, 2][:, None, :]) * y

        f = swiglu(modulate(x, 0), ffn_w_in[i, 0], ffn_w_out[i, 0])
        x = layer_norm(ALPHA * x + FFN_RES * gate(f, 0), ln_g[i, 0], ln_b[i, 0])

        h = modulate(x, 1)
        kind = i % N_MIXERS
        if kind == 0:
            y, new_v = mixer_chunk_mlp(h, *a_p)
        elif kind == 1:
            y, new3 = mixer_short_conv(h, buf3, *b_p)
        elif kind == 2:
            y, new31 = mixer_conformer_conv(h, buf31, *c_p)
        else:
            y, newpool = mixer_pool(h, bufpool, start_pos, *d_p)
        x = layer_norm(ALPHA * x + gate(y, 1), ln_g[i, 1], ln_b[i, 1])

        f = swiglu(modulate(x, 2), ffn_w_in[i, 1], ffn_w_out[i, 1])
        x = layer_norm(ALPHA * x + FFN_RES * gate(f, 2), ln_g[i, 2], ln_b[i, 2])
    return x, new_v, new3, new31, newpool


def setup_inputs(seed: int = 0) -> dict:
    key = jax.random.key(seed)
    ks = iter(jax.random.split(key, 40))

    def nrm(shape, s):
        return jax.random.normal(next(ks), shape, jnp.float32) * s

    D = D_MODEL
    gd = POOL_GROUP_DIM
    return {
        "x_prompt": nrm((BATCH, SEQ, D), 1.0),
        "x_sample": nrm((DEC_BATCH, DEC_SEQ, D), 1.0),
        "c_prompt": nrm((BATCH, D), 1.0),
        "c_sample": nrm((DEC_BATCH, D), 1.0),
        "state_conv3": nrm((DEC_BATCH, B_WIDTH - 1, D), 0.5),
        "state_conv31": nrm((DEC_BATCH, C_WIDTH - 1, D), 0.5),
        "state_pool": nrm((DEC_BATCH, POOL_BUF, D), 1.0),
        "ada_w": nrm((DEPTH, D, 9 * D), 0.1 * D ** -0.5),
        "ada_b": nrm((DEPTH, 9 * D), 0.01),
        "ln_g": 1.0 + nrm((DEPTH, 3, D), 0.05),
        "ln_b": nrm((DEPTH, 3, D), 0.01),
        "ffn_w_in": nrm((DEPTH, 2, D, 2 * D_FF), D ** -0.5),
        "ffn_w_out": nrm((DEPTH, 2, D_FF, D), BETA * D_FF ** -0.5),
        "a_w_in": nrm((D, 2 * A_WIDTH), D ** -0.5),
        "a_b_in": nrm((2 * A_WIDTH,), 0.01),
        "a_ln_g": 1.0 + nrm((A_WIDTH,), 0.05),
        "a_ln_b": nrm((A_WIDTH,), 0.01),
        "a_w_s": nrm((A_GROUPS, CHUNK, CHUNK), CHUNK ** -0.5),
        "a_b_s": 1.0 + nrm((A_GROUPS, CHUNK), 0.01),
        "a_w_out": nrm((A_WIDTH, D), BETA * A_WIDTH ** -0.5),
        "b_w_in": nrm((D, 3 * D), D ** -0.5),
        "b_conv": nrm((B_WIDTH, D), B_WIDTH ** -0.5),
        "b_w_out": nrm((D, D), BETA * D ** -0.5),
        "c_w_pw1": nrm((D, 2 * D), D ** -0.5),
        "c_b_pw1": nrm((2 * D,), 0.01),
        "c_dw": nrm((C_WIDTH, D), C_WIDTH ** -0.5),
        "c_b_dw": nrm((D,), 0.01),
        "c_ln_g": 1.0 + nrm((D,), 0.05),
        "c_ln_b": nrm((D,), 0.01),
        "c_w_pw2": nrm((D, D), BETA * D ** -0.5),
        "c_b_pw2": nrm((D,), 0.01),
        "d_w_grp": nrm((POOL_GROUPS, gd, gd), BETA * gd ** -0.5),
        "d_b_grp": nrm((POOL_GROUPS, gd), 0.01),
        "d_scale": 1.0 + nrm((D,), 0.1),
    }


def reference(x_prompt, x_sample, c_prompt, c_sample, state_conv3, state_conv31, state_pool,
              ada_w, ada_b, ln_g, ln_b, ffn_w_in, ffn_w_out,
              a_w_in, a_b_in, a_ln_g, a_ln_b, a_w_s, a_b_s, a_w_out,
              b_w_in, b_conv, b_w_out,
              c_w_pw1, c_b_pw1, c_dw, c_b_dw, c_ln_g, c_ln_b, c_w_pw2, c_b_pw2,
              d_w_grp, d_b_grp, d_scale):
    shared = (ada_w, ada_b, ln_g, ln_b, ffn_w_in, ffn_w_out)
    a_p = (a_w_in, a_b_in, a_ln_g, a_ln_b, a_w_s, a_b_s, a_w_out)
    b_p = (b_w_in, b_conv, b_w_out)
    c_p = (c_w_pw1, c_b_pw1, c_dw, c_b_dw, c_ln_g, c_ln_b, c_w_pw2, c_b_pw2)
    d_p = (d_w_grp, d_b_grp, d_scale)

    dt = x_prompt.dtype
    z3 = jnp.zeros((BATCH, B_WIDTH - 1, D_MODEL), dt)
    z31 = jnp.zeros((BATCH, C_WIDTH - 1, D_MODEL), dt)
    zpool = jnp.zeros((BATCH, POOL_BUF, D_MODEL), dt)
    y_prompt, v_p, conv3_p, conv31_p, pool_p = run_trunk(
        x_prompt, c_prompt, z3, z31, zpool, 0, shared, a_p, b_p, c_p, d_p)

    y_sample, v_s, conv3_s, conv31_s, pool_s = run_trunk(
        x_sample, c_sample, state_conv3, state_conv31, state_pool, PAST_LEN,
        shared, a_p, b_p, c_p, d_p)

    return (y_prompt, y_sample, v_p, v_s, conv3_p, conv3_s, conv31_p, conv31_s, pool_p, pool_s)
```

```cpp
#include <hip/hip_runtime.h>
#include <hip/hip_cooperative_groups.h>
#include <cstdio>
namespace cg = cooperative_groups;

#ifndef MULTI_LAUNCH
#define MULTI_LAUNCH 0
#endif

#define LAS __attribute__((address_space(3)))
typedef unsigned short bf16_t;
typedef short bf16x8 __attribute__((ext_vector_type(8)));
typedef float f32x4 __attribute__((ext_vector_type(4)));
typedef float f32x2 __attribute__((ext_vector_type(2)));
typedef unsigned u32x4 __attribute__((ext_vector_type(4)));
typedef unsigned u32x2 __attribute__((ext_vector_type(2)));

constexpr int D = 1024, NPR = 16384, NSR = 1024, MROWS = NPR + NSR, DFF = 2816, NCOND = 136, MODW = 36864;
constexpr int SEQ = 2048, DSEQ = 8, NB = 8, NDB = 128;
constexpr float ALPHA = 1.6817928305074292f, LN_EPS = 1e-5f;

enum { I_XP = 0, I_XS, I_CP, I_CS, I_ST3, I_ST31, I_STP, I_ADAW, I_ADAB, I_LNG, I_LNB, I_FWIN, I_FWOUT, I_AWIN, I_ABIN, I_ALNG, I_ALNB, I_AWS, I_ABS, I_AWOUT,
       I_BWIN, I_BCONV, I_BWOUT, I_CPW1, I_CBPW1, I_CDW, I_CBDW, I_CLNG, I_CLNB, I_CPW2, I_CBPW2, I_DWG, I_DBG, I_DSC, N_IN };

constexpr size_t O_YP = 0, O_YS = O_YP + (size_t)NPR * D, O_VP = O_YS + (size_t)NSR * D, O_VS = O_VP + (size_t)NB * 128 * D, O_C3P = O_VS + (size_t)NDB * 8 * D,
                 O_C3S = O_C3P + (size_t)NB * 2 * D, O_C31P = O_C3S + (size_t)NDB * 2 * D, O_C31S = O_C31P + (size_t)NB * 30 * D, O_PP = O_C31S + (size_t)NDB * 30 * D,
                 O_PS = O_PP + (size_t)NB * 15 * D, O_END = O_PS + (size_t)NDB * 15 * D;

constexpr size_t W_FIN = 0;
constexpr size_t W_FOUT = W_FIN + (size_t)8 * 5632 * 1024 * 2;
constexpr size_t W_ADA = W_FOUT + (size_t)8 * 1024 * 2816 * 2;
constexpr size_t W_AIN = W_ADA + (size_t)36864 * 1024 * 2;
constexpr size_t W_AOUT = W_AIN + (size_t)2048 * 1024 * 2;
constexpr size_t W_BIN = W_AOUT + (size_t)1024 * 1024 * 2;
constexpr size_t W_BOUT = W_BIN + (size_t)3072 * 1024 * 2;
constexpr size_t W_CPW1 = W_BOUT + (size_t)1024 * 1024 * 2;
constexpr size_t W_CPW2 = W_CPW1 + (size_t)2048 * 1024 * 2;
constexpr size_t W_DG = W_CPW2 + (size_t)1024 * 1024 * 2;
constexpr size_t W_SC = W_DG + (size_t)4 * 256 * 256 * 2;
constexpr size_t W_MOD = W_SC + (size_t)256 * 1024 * 2;
constexpr size_t W_X = W_MOD + (size_t)256 * MODW * 4;
constexpr size_t W_Z = W_X + (size_t)MROWS * D * 4;
constexpr size_t W_H = W_Z + (size_t)MROWS * D * 4;
constexpr size_t W_BIG = W_H + (size_t)MROWS * D * 2;
constexpr size_t W_Y2 = W_BIG + (size_t)MROWS * 3072 * 2;
constexpr size_t W_END = W_Y2 + (size_t)MROWS * D * 2;

struct Params { const float* in[N_IN]; float* out; unsigned char* ws; };

__device__ __forceinline__ int cond_of(int r) { return r < NPR ? (r >> 11) : 8 + ((r - NPR) >> 3); }
__device__ __forceinline__ float bf_lo(unsigned w) { return __uint_as_float(w << 16); }
__device__ __forceinline__ float bf_hi(unsigned w) { return __uint_as_float(w & 0xffff0000u); }
__device__ __forceinline__ unsigned cvt_pk_bf16(float lo, float hi) { unsigned r; asm volatile("v_cvt_pk_bf16_f32 %0, %1, %2" : "=v"(r) : "v"(lo), "v"(hi)); return r; }
__device__ __forceinline__ float sigmoid_f(float x) { return __builtin_amdgcn_rcpf(1.0f + __expf(-x)); }
__device__ __forceinline__ float silu_f(float x) { return x * sigmoid_f(x); }
__device__ __forceinline__ float gelu_tanh_f(float x) { const float u = 0.7978845608028654f * (x + 0.044715f * x * x * x); return x * sigmoid_f(2.0f * u); }
__device__ __forceinline__ float wave_sum(float v) {
#pragma unroll
    for (int o = 1; o < 64; o <<= 1) v += __shfl_xor(v, o);
    return v;
}

namespace pg8 {
constexpr int BM = 256, BK = 64, HALF = 128, HTB = HALF * BK * 2, STAGE_BYTES = 8 * HTB, NXCD = 8, WGM = 8;
__host__ __device__ __forceinline__ int lds_byte(int r, int c) { const int st = (r >> 4) * 2 + (c >> 5), rr = r & 15, cc = c & 31, ob = rr * 64 + cc * 2; return st * 1024 + (ob ^ (((ob >> 9) & 1) << 5)); }
__host__ __device__ __forceinline__ void stage_rc(int b, int& R, int& C) { const int st = b / 1024, sb = b % 1024, swz = sb ^ (((sb >> 9) & 1) << 5); R = (st >> 1) * 16 + swz / 64; C = (st & 1) * 32 + (swz % 64) / 2; }
__host__ __device__ __forceinline__ int perm32(int rho) { const int n = rho >> 4, i = rho & 15; return 8 * (i >> 2) + 4 * n + (i & 3); }

struct Unit { int pm, pn; };
struct Gemm { const bf16_t* A; const bf16_t* Bt; int lda, ldb, K, a_pn_off; };

struct StaticOrder {
    int nM, nN, nwg, G, c;
    __host__ __device__ void init(int M, int N, int G_, int c_) { nM = M / BM; nN = N / BM; nwg = nM * nN; G = G_; c = c_; }
    __host__ __device__ bool next(int i, Unit& u) const {
        const long L = (long)i * G + c; if (L >= nwg) return false;
        int wgid = (int)L; { const int q = nwg / NXCD, r = nwg % NXCD, xcd = wgid % NXCD, off = wgid / NXCD; wgid = (xcd < r ? xcd * (q + 1) : r * (q + 1) + (xcd - r) * q) + off; }
        const int nig = WGM * nN, gid = wgid / nig, fm = gid * WGM, gsz = (nM - fm) < WGM ? (nM - fm) : WGM;
        u.pm = fm + ((wgid % nig) % gsz); u.pn = (wgid % nig) / gsz; return true;
    }
    __device__ __forceinline__ void a_ready(const Unit&) const {}
    __device__ __forceinline__ void done(const Unit&) const {}
};

struct EpiF32 {
    static constexpr bool PERM = false;
    float* C; int ldc; const float* bias;
    __device__ __forceinline__ void operator()(const f32x4 (&acc)[2][2][4][2], const Unit& u, int wr, int wc, int fr, int fq) const {
        const int row0 = u.pm * BM + wr * 64 + fr, col0 = u.pn * BM + wc * 32 + 4 * fq;
        f32x4 bv[2][2];
#pragma unroll
        for (int bj = 0; bj < 2; ++bj)
#pragma unroll
            for (int n = 0; n < 2; ++n) bv[bj][n] = *(const f32x4*)(bias + col0 + bj * HALF + n * 16);
#pragma unroll
        for (int ai = 0; ai < 2; ++ai)
#pragma unroll
            for (int m = 0; m < 4; ++m) { float* rowp = C + (size_t)(row0 + ai * HALF + m * 16) * ldc + col0;
#pragma unroll
                for (int bj = 0; bj < 2; ++bj)
#pragma unroll
                    for (int n = 0; n < 2; ++n) *(f32x4*)(rowp + bj * HALF + n * 16) = acc[ai][bj][m][n] + bv[bj][n]; }
    }
};
template <int ACT  > struct EpiBf16 {
    static constexpr bool PERM = true;
    bf16_t* O; int ldc; const float* bias;
    __device__ __forceinline__ void operator()(const f32x4 (&acc)[2][2][4][2], const Unit& u, int wr, int wc, int fr, int fq) const {
        const int row0 = u.pm * BM + wr * 64 + fr; const int col0 = u.pn * BM + wc * 32 + 8 * fq;
        f32x4 bv[2][2];
#pragma unroll
        for (int bj = 0; bj < 2; ++bj)
#pragma unroll
            for (int n = 0; n < 2; ++n) bv[bj][n] = bias ? *(const f32x4*)(bias + col0 + bj * HALF + 4 * n) : (f32x4){0.f, 0.f, 0.f, 0.f};
#pragma unroll
        for (int ai = 0; ai < 2; ++ai)
#pragma unroll
            for (int m = 0; m < 4; ++m) { bf16_t* rowp = O + (size_t)(row0 + ai * HALF + m * 16) * ldc + col0;
#pragma unroll
                for (int bj = 0; bj < 2; ++bj) { f32x4 v0 = acc[ai][bj][m][0] + bv[bj][0], v1 = acc[ai][bj][m][1] + bv[bj][1];
                    if (ACT == 1) {
#pragma unroll
                        for (int j = 0; j < 4; ++j) { v0[j] = gelu_tanh_f(v0[j]); v1[j] = gelu_tanh_f(v1[j]); } }
                    u32x4 w; w.x = cvt_pk_bf16(v0[0], v0[1]); w.y = cvt_pk_bf16(v0[2], v0[3]); w.z = cvt_pk_bf16(v1[0], v1[1]); w.w = cvt_pk_bf16(v1[2], v1[3]);
                    *(u32x4*)(rowp + bj * HALF) = w; } }
    }
};
template <int MODE> struct EpiPair {
    static constexpr bool PERM = true;
    bf16_t* O; int ldc; const float* bias; int nhalf;
    __device__ __forceinline__ void operator()(const f32x4 (&acc)[2][2][4][2], const Unit& u, int wr, int wc, int fr, int fq) const {
        const int row0 = u.pm * BM + wr * 64 + fr; const int col0 = u.pn * HALF + wc * 32 + 8 * fq;
        f32x4 b1[2], b2[2];
#pragma unroll
        for (int n = 0; n < 2; ++n) { b1[n] = (MODE == 1) ? *(const f32x4*)(bias + col0 + 4 * n) : (f32x4){0.f, 0.f, 0.f, 0.f}; b2[n] = (MODE == 1) ? *(const f32x4*)(bias + nhalf + col0 + 4 * n) : (f32x4){0.f, 0.f, 0.f, 0.f}; }
#pragma unroll
        for (int ai = 0; ai < 2; ++ai)
#pragma unroll
            for (int m = 0; m < 4; ++m) { bf16_t* rowp = O + (size_t)(row0 + ai * HALF + m * 16) * ldc + col0;
                f32x4 o[2];
#pragma unroll
                for (int n = 0; n < 2; ++n) { const f32x4 p = acc[ai][0][m][n] + b1[n], q = acc[ai][1][m][n] + b2[n];
#pragma unroll
                    for (int j = 0; j < 4; ++j) o[n][j] = (MODE == 0) ? silu_f(p[j]) * q[j] : p[j] * sigmoid_f(q[j]); }
                u32x4 w; w.x = cvt_pk_bf16(o[0][0], o[0][1]); w.y = cvt_pk_bf16(o[0][2], o[0][3]); w.z = cvt_pk_bf16(o[1][0], o[1][1]); w.w = cvt_pk_bf16(o[1][2], o[1][3]);
                *(u32x4*)rowp = w; }
    }
};
struct EpiRes {
    static constexpr bool PERM = false;
    const float* X; float* Z; const float* gate; const float* bias; const float* cscale; float coef;
    __device__ __forceinline__ void operator()(const f32x4 (&acc)[2][2][4][2], const Unit& u, int wr, int wc, int fr, int fq) const {
        const int row0 = u.pm * BM + wr * 64 + fr, col0 = u.pn * BM + wc * 32 + 4 * fq;
#pragma unroll
        for (int ai = 0; ai < 2; ++ai)
#pragma unroll
            for (int m = 0; m < 4; ++m) { const int r = row0 + ai * HALF + m * 16; const float* gp = gate + (size_t)cond_of(r) * MODW + col0; const size_t off = (size_t)r * D + col0;
#pragma unroll
                for (int bj = 0; bj < 2; ++bj)
#pragma unroll
                    for (int n = 0; n < 2; ++n) { const int co = bj * HALF + n * 16;
                        const f32x4 gt = *(const f32x4*)(gp + co), xv = *(const f32x4*)(X + off + co);
                        f32x4 v = acc[ai][bj][m][n];
                        if (bias) v += *(const f32x4*)(bias + col0 + co);
                        if (cscale) v *= *(const f32x4*)(cscale + col0 + co);
                        *(f32x4*)(Z + off + co) = ALPHA * xv + coef * ((1.0f + gt) * v); }
                asm volatile("" ::: "memory"); }
    }
};

template <class Epi, class Sched>
__device__ __forceinline__ void gemm_phase(LAS unsigned char* lds, const Gemm g, const Sched& S, const Epi& E, const int tid) {
    const int wid = __builtin_amdgcn_readfirstlane(tid >> 6), lane = tid & 63, wr = wid >> 2, wc = wid & 3, fr = lane & 15, fq = lane >> 4;
    const int K = g.K, nt = K / BK;
    unsigned voffA[2], voffB[2];
#pragma unroll
    for (int i = 0; i < 2; ++i) { int R, C; stage_rc(tid * 16 + i * 8192, R, C); const int Rb = Epi::PERM ? ((R & ~31) + perm32(R & 31)) : R;
        voffA[i] = (unsigned)(R * g.lda + C) * 2u; voffB[i] = (unsigned)(Rb * g.ldb + C) * 2u; }
    const size_t kstep = (size_t)(BK * 2);
    const size_t hstepA = (size_t)HALF * g.lda * 2, hstepB = (size_t)HALF * g.ldb * 2;
    const size_t tstepA = 2 * hstepA, tstepB = 2 * hstepB;
    const unsigned ldsw = (unsigned)wid * 1024u;
    const int aoff = lds_byte(wr * 64 + fr, fq * 8), boff = lds_byte(wc * 32 + fr, fq * 8);
#define PG8_SA(b, h) (((b) * 2 + (h)) * HTB)
#define PG8_SB(b, h) ((4 + (b) * 2 + (h)) * HTB)
#define PG8_STAGE(bufoff, gbase, voff) do { _Pragma("unroll") for (int _i = 0; _i < 2; ++_i) \
        __builtin_amdgcn_global_load_lds((const unsigned*)((const char*)(gbase) + (voff)[_i]), (LAS unsigned*)(lds + (bufoff) + ldsw + _i * 8192), 16, 0, 0); } while (0)
#define PG8_LDA(dst, b, h) do { _Pragma("unroll") for (int m = 0; m < 4; ++m) _Pragma("unroll") for (int k = 0; k < 2; ++k) dst[m][k] = *(const LAS bf16x8*)(lds + PG8_SA(b, h) + aoff + m * 2048 + k * 1024); } while (0)
#define PG8_LDB(dst, b, h) do { _Pragma("unroll") for (int n = 0; n < 2; ++n) _Pragma("unroll") for (int k = 0; k < 2; ++k) dst[n][k] = *(const LAS bf16x8*)(lds + PG8_SB(b, h) + boff + n * 2048 + k * 1024); } while (0)
#define PG8_MMA(ai, bj, At, Bt) do { __builtin_amdgcn_s_setprio(1); _Pragma("unroll") for (int m = 0; m < 4; ++m) _Pragma("unroll") for (int n = 0; n < 2; ++n) _Pragma("unroll") for (int k = 0; k < 2; ++k) \
        acc[ai][bj][m][n] = __builtin_amdgcn_mfma_f32_16x16x32_bf16(Bt[n][k], At[m][k], acc[ai][bj][m][n], 0, 0, 0); __builtin_amdgcn_s_setprio(0); } while (0)
#define PG8_WAIT_V(n) asm volatile("s_waitcnt vmcnt(" #n ")" ::: "memory")
#define PG8_WAIT_L(n) asm volatile("s_waitcnt lgkmcnt(" #n ")" ::: "memory")
#define PG8_BAR __builtin_amdgcn_s_barrier()
#define PG8_SCHED __builtin_amdgcn_sched_barrier(0)
    Unit cur, nxt; int ui = 0;
    if (!S.next(0, cur)) return;
    f32x4 acc[2][2][4][2];
#pragma unroll
    for (int a = 0; a < 2; ++a)
#pragma unroll
        for (int b = 0; b < 2; ++b)
#pragma unroll
            for (int m = 0; m < 4; ++m)
#pragma unroll
                for (int n = 0; n < 2; ++n) acc[a][b][m][n] = (f32x4){0.f, 0.f, 0.f, 0.f};
    bf16x8 At[4][2], B0[2][2], B1[2][2];
    const char* cA = (const char*)g.A + (size_t)cur.pm * tstepA + (size_t)cur.pn * g.a_pn_off * 2; const char* cB = (const char*)g.Bt + (size_t)cur.pn * tstepB;
    S.a_ready(cur);
    PG8_STAGE(PG8_SB(0, 0), cB, voffB); PG8_STAGE(PG8_SA(0, 0), cA, voffA); PG8_STAGE(PG8_SB(0, 1), cB + hstepB, voffB); PG8_STAGE(PG8_SA(0, 1), cA + hstepA, voffA);
    if (wr == 1) PG8_BAR;
    PG8_WAIT_V(4); PG8_BAR;
    PG8_STAGE(PG8_SB(1, 0), cB + kstep, voffB); PG8_STAGE(PG8_SA(1, 0), cA + kstep, voffA); PG8_STAGE(PG8_SB(1, 1), cB + hstepB + kstep, voffB);
    PG8_WAIT_V(6); PG8_BAR;
    for (;;) {
        const bool has_next = S.next(ui + 1, nxt);
        const char* nA = has_next ? (const char*)g.A + (size_t)nxt.pm * tstepA + (size_t)nxt.pn * g.a_pn_off * 2 : cA; const char* nB = has_next ? (const char*)g.Bt + (size_t)nxt.pn * tstepB : cB;
        for (int t = 0; t < nt; t += 2) {
            const bool last = (t == nt - 2);
            const char* a1 = cA + (size_t)(t + 1) * kstep;
            const char* a2 = last ? nA : cA + (size_t)(t + 2) * kstep; const char* b2 = last ? nB : cB + (size_t)(t + 2) * kstep;
            const char* a3 = a2 + kstep; const char* b3 = b2 + kstep;
            if (last && has_next) S.a_ready(nxt);
            PG8_LDB(B0, 0, 0); PG8_SCHED; PG8_LDA(At, 0, 0); PG8_STAGE(PG8_SA(1, 1), a1 + hstepA, voffA);
            PG8_WAIT_L(8); PG8_BAR; PG8_WAIT_L(0); PG8_MMA(0, 0, At, B0); PG8_BAR; PG8_SCHED;
            PG8_LDB(B1, 0, 1); PG8_STAGE(PG8_SB(0, 0), b2, voffB);
            PG8_BAR; PG8_WAIT_L(0); PG8_MMA(0, 1, At, B1); PG8_BAR;
            PG8_LDA(At, 0, 1); PG8_STAGE(PG8_SA(0, 0), a2, voffA);
            PG8_BAR; PG8_WAIT_L(0); PG8_MMA(1, 0, At, B0); PG8_BAR; PG8_SCHED;
            PG8_STAGE(PG8_SB(0, 1), b2 + hstepB, voffB);
            PG8_WAIT_V(6); PG8_BAR; PG8_MMA(1, 1, At, B1); PG8_BAR;
            PG8_LDB(B0, 1, 0); PG8_SCHED; PG8_LDA(At, 1, 0); PG8_STAGE(PG8_SA(0, 1), a2 + hstepA, voffA);
            PG8_WAIT_L(8); PG8_BAR; PG8_WAIT_L(0); PG8_MMA(0, 0, At, B0); PG8_BAR; PG8_SCHED;
            PG8_LDB(B1, 1, 1); PG8_STAGE(PG8_SB(1, 0), b3, voffB);
            PG8_BAR; PG8_WAIT_L(0); PG8_MMA(0, 1, At, B1); PG8_BAR;
            PG8_LDA(At, 1, 1); PG8_STAGE(PG8_SA(1, 0), a3, voffA);
            PG8_BAR; PG8_WAIT_L(0); PG8_MMA(1, 0, At, B0); PG8_BAR; PG8_SCHED;
            PG8_STAGE(PG8_SB(1, 1), b3 + hstepB, voffB);
            PG8_WAIT_V(6); PG8_BAR; PG8_MMA(1, 1, At, B1); PG8_BAR;
        }
        E(acc, cur, wr, wc, fr, fq); S.done(cur);
        if (!has_next) break;
#pragma unroll
        for (int a = 0; a < 2; ++a)
#pragma unroll
            for (int b = 0; b < 2; ++b)
#pragma unroll
                for (int m = 0; m < 4; ++m)
#pragma unroll
                    for (int n = 0; n < 2; ++n) acc[a][b][m][n] = (f32x4){0.f, 0.f, 0.f, 0.f};
        cur = nxt; cA = nA; cB = nB; ++ui;
    }
    PG8_WAIT_V(0);
    if (wr == 0) PG8_BAR;
    PG8_BAR;
#undef PG8_SA
#undef PG8_SB
#undef PG8_STAGE
#undef PG8_LDA
#undef PG8_LDB
#undef PG8_MMA
#undef PG8_WAIT_V
#undef PG8_WAIT_L
#undef PG8_BAR
#undef PG8_SCHED
}
}

__device__ __forceinline__ void transpose_item(const float* W, int K, int N, bf16_t* WT, int half, LAS float* scr, int item, int lane) {
    const int nblk = N / 32, kb = item / nblk, nb = item % nblk, k0 = 64 * kb, n0 = 32 * nb;
#pragma unroll 8
    for (int i = 0; i < 32; ++i) { const int kk = 2 * i + (lane >> 5); scr[kk * 33 + (lane & 31)] = W[(size_t)(k0 + kk) * N + n0 + (lane & 31)]; }
    asm volatile("s_waitcnt lgkmcnt(0)" ::: "memory");
    int d0 = n0;
    if (half) { const int j = n0 < half ? n0 : n0 - half; d0 = 256 * (j >> 7) + (j & 127) + (n0 < half ? 0 : 128); }
    const int c = lane & 7;
#pragma unroll
    for (int j = 0; j < 4; ++j) { const int n = (lane >> 3) + 8 * j; const LAS float* s = scr + (8 * c) * 33 + n;
        u32x4 o; o.x = cvt_pk_bf16(s[0 * 33], s[1 * 33]); o.y = cvt_pk_bf16(s[2 * 33], s[3 * 33]); o.z = cvt_pk_bf16(s[4 * 33], s[5 * 33]); o.w = cvt_pk_bf16(s[6 * 33], s[7 * 33]);
        *(u32x4*)(WT + (size_t)(d0 + n) * K + k0 + 8 * c) = o; }
    asm volatile("s_waitcnt lgkmcnt(0)" ::: "memory");
}

__device__ __forceinline__ void p0_phase(const Params& p, LAS unsigned char* lds, const int tid, const int bid, const int NG) {
    const int wave = tid >> 6, lane = tid & 63;
    LAS float* scr = (LAS float*)(lds + wave * 8448);
    const int gw = bid * 8 + wave, NGW = NG * 8;
    constexpr int I_FIN = 16 * 176, I_FOUT = 44 * 32, I_ADA = 16 * 288, I_AIN = 16 * 64, I_SQ = 16 * 32, I_BIN = 16 * 96, I_DG = 4 * 8;
    constexpr int NITEMS = 8 * I_FIN + 8 * I_FOUT + 4 * I_ADA + I_AIN + I_SQ + I_BIN + I_SQ + I_AIN + I_SQ + 4 * I_DG;
    unsigned char* ws = p.ws;
    for (int it = gw; it < NITEMS; it += NGW) {
        int r = it;
        if (r < 8 * I_FIN) { const int mi = r / I_FIN; transpose_item(p.in[I_FWIN] + (size_t)mi * 1024 * 5632, 1024, 5632, (bf16_t*)(ws + W_FIN) + (size_t)mi * 5632 * 1024, 2816, scr, r % I_FIN, lane); continue; } r -= 8 * I_FIN;
        if (r < 8 * I_FOUT) { const int mi = r / I_FOUT; transpose_item(p.in[I_FWOUT] + (size_t)mi * 2816 * 1024, 2816, 1024, (bf16_t*)(ws + W_FOUT) + (size_t)mi * 1024 * 2816, 0, scr, r % I_FOUT, lane); continue; } r -= 8 * I_FOUT;
        if (r < 4 * I_ADA) { const int mi = r / I_ADA; transpose_item(p.in[I_ADAW] + (size_t)mi * 1024 * 9216, 1024, 9216, (bf16_t*)(ws + W_ADA) + (size_t)mi * 9216 * 1024, 0, scr, r % I_ADA, lane); continue; } r -= 4 * I_ADA;
        if (r < I_AIN) { transpose_item(p.in[I_AWIN], 1024, 2048, (bf16_t*)(ws + W_AIN), 0, scr, r, lane); continue; } r -= I_AIN;
        if (r < I_SQ) { transpose_item(p.in[I_AWOUT], 1024, 1024, (bf16_t*)(ws + W_AOUT), 0, scr, r, lane); continue; } r -= I_SQ;
        if (r < I_BIN) { transpose_item(p.in[I_BWIN], 1024, 3072, (bf16_t*)(ws + W_BIN), 0, scr, r, lane); continue; } r -= I_BIN;
        if (r < I_SQ) { transpose_item(p.in[I_BWOUT], 1024, 1024, (bf16_t*)(ws + W_BOUT), 0, scr, r, lane); continue; } r -= I_SQ;
        if (r < I_AIN) { transpose_item(p.in[I_CPW1], 1024, 2048, (bf16_t*)(ws + W_CPW1), 1024, scr, r, lane); continue; } r -= I_AIN;
        if (r < I_SQ) { transpose_item(p.in[I_CPW2], 1024, 1024, (bf16_t*)(ws + W_CPW2), 0, scr, r, lane); continue; } r -= I_SQ;
        { const int mi = r / I_DG; transpose_item(p.in[I_DWG] + (size_t)mi * 256 * 256, 256, 256, (bf16_t*)(ws + W_DG) + (size_t)mi * 256 * 256, 0, scr, r % I_DG, lane); }
    }
    bf16_t* SC = (bf16_t*)(ws + W_SC);
    for (int i = bid * 512 + tid; i < 256 * 1024 / 2; i += NG * 512) {
        const int row = (2 * i) >> 10, col = (2 * i) & 1023; float a = 0.f, b = 0.f;
        if (row < NCOND) { const float* c = row < NB ? p.in[I_CP] + (size_t)row * D : p.in[I_CS] + (size_t)(row - NB) * D; a = silu_f(c[col]); b = silu_f(c[col + 1]); }
        ((unsigned*)SC)[i] = cvt_pk_bf16(a, b);
    }
}

template <bool DO_LN>
__device__ __forceinline__ void ln_phase(const Params& p, const float* Zsrc, float* Xout, bf16_t* Hout, const float* g, const float* b, const float* modbase, const int tid, const int bid, const int NG) {
    const int wave = tid >> 6, lane = tid & 63;
    const int gw = bid * 8 + wave, NGW = NG * 8;
    for (int r = gw; r < MROWS; r += NGW) {
        const float* src = DO_LN ? Zsrc + (size_t)r * D : (r < NPR ? p.in[I_XP] + (size_t)r * D : p.in[I_XS] + (size_t)(r - NPR) * D);
        f32x4 v[4];
#pragma unroll
        for (int j = 0; j < 4; ++j) v[j] = *(const f32x4*)(src + lane * 4 + 256 * j);
        if (DO_LN) {
            float s = 0.f;
#pragma unroll
            for (int j = 0; j < 4; ++j) s += (v[j][0] + v[j][1]) + (v[j][2] + v[j][3]);
            const float mean = wave_sum(s) * (1.0f / D); float q = 0.f;
#pragma unroll
            for (int j = 0; j < 4; ++j) { v[j] = v[j] - mean; q += (v[j][0] * v[j][0] + v[j][1] * v[j][1]) + (v[j][2] * v[j][2] + v[j][3] * v[j][3]); }
            const float rstd = 1.0f / sqrtf(wave_sum(q) * (1.0f / D) + LN_EPS);
#pragma unroll
            for (int j = 0; j < 4; ++j) { const f32x4 gv = *(const f32x4*)(g + lane * 4 + 256 * j), bv = *(const f32x4*)(b + lane * 4 + 256 * j); v[j] = v[j] * rstd * gv + bv; }
        }
#pragma unroll
        for (int j = 0; j < 4; ++j) *(f32x4*)(Xout + (size_t)r * D + lane * 4 + 256 * j) = v[j];
        if (Hout) {
            const float* mp = modbase + (size_t)cond_of(r) * MODW;
#pragma unroll
            for (int j = 0; j < 4; ++j) { const f32x4 sh = *(const f32x4*)(mp + lane * 4 + 256 * j), sc = *(const f32x4*)(mp + D + lane * 4 + 256 * j);
                const f32x4 h = v[j] * (1.0f + sc) + sh; u32x2 w; w.x = cvt_pk_bf16(h[0], h[1]); w.y = cvt_pk_bf16(h[2], h[3]);
                *(u32x2*)(Hout + (size_t)r * D + lane * 4 + 256 * j) = w; }
        }
    }
}

__device__ __forceinline__ void unpack8(const u32x4 w, float (&f)[8]) { f[0] = bf_lo(w.x); f[1] = bf_hi(w.x); f[2] = bf_lo(w.y); f[3] = bf_hi(w.y); f[4] = bf_lo(w.z); f[5] = bf_hi(w.z); f[6] = bf_lo(w.w); f[7] = bf_hi(w.w); }
__device__ __forceinline__ void load8f(const float* s, float (&f)[8]) { const f32x4 a = *(const f32x4*)s, b = *(const f32x4*)(s + 4); f[0] = a[0]; f[1] = a[1]; f[2] = a[2]; f[3] = a[3]; f[4] = b[0]; f[5] = b[1]; f[6] = b[2]; f[7] = b[3]; }
__device__ __forceinline__ void store8f(float* d, const float (&f)[8]) { *(f32x4*)d = (f32x4){f[0], f[1], f[2], f[3]}; *(f32x4*)(d + 4) = (f32x4){f[4], f[5], f[6], f[7]}; }
__device__ __forceinline__ u32x4 pack8(const float (&f)[8]) { u32x4 w; w.x = cvt_pk_bf16(f[0], f[1]); w.y = cvt_pk_bf16(f[2], f[3]); w.z = cvt_pk_bf16(f[4], f[5]); w.w = cvt_pk_bf16(f[6], f[7]); return w; }

__device__ __forceinline__ void b2_phase(const Params& p, const int tid, const int bid, const int NG) {
    const bf16_t* P = (const bf16_t*)(p.ws + W_BIG); bf16_t* Y2 = (bf16_t*)(p.ws + W_Y2);
    const float* cw = p.in[I_BCONV]; const float* st = p.in[I_ST3];
    for (int it = bid * 512 + tid; it < MROWS * 128; it += NG * 512) {
        const int r = it >> 7, c = (it & 127) * 8; const bool smp = r >= NPR; const int b = smp ? (r - NPR) >> 3 : r >> 11, t = smp ? (r - NPR) & 7 : r & 2047;
        const bf16_t* pr = P + (size_t)r * 3072 + c;
        float bg[8], a[8], x[8], cx0[8], cx1[8], cx2[8];
        unpack8(*(const u32x4*)pr, bg); unpack8(*(const u32x4*)(pr + 1024), a); unpack8(*(const u32x4*)(pr + 2048), x);
#pragma unroll
        for (int e = 0; e < 8; ++e) cx0[e] = a[e] * x[e];
        if (t >= 1) { unpack8(*(const u32x4*)(pr - 3072 + 1024), a); unpack8(*(const u32x4*)(pr - 3072 + 2048), x);
#pragma unroll
            for (int e = 0; e < 8; ++e) cx1[e] = a[e] * x[e]; }
        else if (smp) load8f(st + ((size_t)b * 2 + 1) * D + c, cx1);
        else {
#pragma unroll
            for (int e = 0; e < 8; ++e) cx1[e] = 0.f; }
        if (t >= 2) { unpack8(*(const u32x4*)(pr - 2 * 3072 + 1024), a); unpack8(*(const u32x4*)(pr - 2 * 3072 + 2048), x);
#pragma unroll
            for (int e = 0; e < 8; ++e) cx2[e] = a[e] * x[e]; }
        else if (smp) load8f(st + ((size_t)b * 2 + t) * D + c, cx2);
        else {
#pragma unroll
            for (int e = 0; e < 8; ++e) cx2[e] = 0.f; }
        float w0[8], w1[8], w2[8], y[8]; load8f(cw + c, w0); load8f(cw + D + c, w1); load8f(cw + 2 * D + c, w2);
#pragma unroll
        for (int e = 0; e < 8; ++e) y[e] = bg[e] * (w0[e] * cx2[e] + w1[e] * cx1[e] + w2[e] * cx0[e]);
        *(u32x4*)(Y2 + (size_t)r * D + c) = pack8(y);
        if (!smp && t >= SEQ - 2) store8f(p.out + O_C3P + ((size_t)b * 2 + (t - (SEQ - 2))) * D + c, cx0);
        if (smp && t >= DSEQ - 2) store8f(p.out + O_C3S + ((size_t)b * 2 + (t - (DSEQ - 2))) * D + c, cx0);
    }
}

__device__ __forceinline__ void d1_phase(const Params& p, const int tid, const int bid, const int NG) {
    const bf16_t* H = (const bf16_t*)(p.ws + W_H); bf16_t* Y2 = (bf16_t*)(p.ws + W_Y2); const float* st = p.in[I_STP];
    for (int it = bid * 512 + tid; it < MROWS * 128; it += NG * 512) {
        const int r = it >> 7, c = (it & 127) * 8; const bool smp = r >= NPR; const int b = smp ? (r - NPR) >> 3 : r >> 11, t = smp ? (r - NPR) & 7 : r & 2047;
        const int w = 2 << (c >> 8);
        float h[8], s[8], x[8];
        unpack8(*(const u32x4*)(H + (size_t)r * D + c), h);
#pragma unroll
        for (int e = 0; e < 8; ++e) s[e] = h[e];
        for (int j = 1; j < w; ++j) { const int tt = t - j;
            if (tt >= 0) { unpack8(*(const u32x4*)(H + (size_t)(r - j) * D + c), x);
#pragma unroll
                for (int e = 0; e < 8; ++e) s[e] += x[e]; }
            else if (smp) { load8f(st + ((size_t)b * 15 + (15 + tt)) * D + c, x);
#pragma unroll
                for (int e = 0; e < 8; ++e) s[e] += x[e]; } }
        const float inv = 1.0f / (float)(smp ? w : (t + 1 < w ? t + 1 : w));
        float d[8];
#pragma unroll
        for (int e = 0; e < 8; ++e) d[e] = s[e] * inv - h[e];
        *(u32x4*)(Y2 + (size_t)r * D + c) = pack8(d);
        if (!smp && t >= SEQ - 15) store8f(p.out + O_PP + ((size_t)b * 15 + (t - (SEQ - 15))) * D + c, h);
        if (smp) { store8f(p.out + O_PS + ((size_t)b * 15 + 7 + t) * D + c, h);
            if (t < 7) { load8f(st + ((size_t)b * 15 + 8 + t) * D + c, x); store8f(p.out + O_PS + ((size_t)b * 15 + t) * D + c, x); } }
    }
}

__device__ __forceinline__ void c2_phase(const Params& p, LAS unsigned char* lds, const int tid, const int bid, const int NG) {
    const bf16_t* G = (const bf16_t*)(p.ws + W_BIG); bf16_t* Y2 = (bf16_t*)(p.ws + W_Y2); const float* st = p.in[I_ST31];
    const int wave = tid >> 6, lane = tid & 63, slab = wave & 3, rsel = wave >> 2, c = slab * 256 + lane * 4;
    LAS float* part = (LAS float*)lds;
    f32x4 wk[31];
#pragma unroll
    for (int k = 0; k < 31; ++k) wk[k] = *(const f32x4*)(p.in[I_CDW] + (size_t)k * D + c);
    const f32x4 bdw = *(const f32x4*)(p.in[I_CBDW] + c), lg = *(const f32x4*)(p.in[I_CLNG] + c), lb = *(const f32x4*)(p.in[I_CLNB] + c);
    for (int pi = bid; pi < MROWS / 2; pi += NG) {
        const int r = 2 * pi + rsel; const bool smp = r >= NPR; const int b = smp ? (r - NPR) >> 3 : r >> 11, t = smp ? (r - NPR) & 7 : r & 2047;
        f32x4 acc = bdw;
#pragma unroll
        for (int k = 0; k < 31; ++k) { const int j = t + k - 30;
            if (j >= 0) { const u32x2 w = *(const u32x2*)(G + (size_t)(r - t + j) * D + c); acc += wk[k] * (f32x4){bf_lo(w.x), bf_hi(w.x), bf_lo(w.y), bf_hi(w.y)}; }
            else if (smp) { acc += wk[k] * *(const f32x4*)(st + ((size_t)b * 30 + (30 + j)) * D + c); } }
        float s = (acc[0] + acc[1]) + (acc[2] + acc[3]), q = (acc[0] * acc[0] + acc[1] * acc[1]) + (acc[2] * acc[2] + acc[3] * acc[3]);
        s = wave_sum(s); q = wave_sum(q);
        if (lane == 0) { part[(rsel * 4 + slab) * 2] = s; part[(rsel * 4 + slab) * 2 + 1] = q; }
        __syncthreads();
        float ts = 0.f, tq = 0.f;
#pragma unroll
        for (int i = 0; i < 4; ++i) { ts += part[(rsel * 4 + i) * 2]; tq += part[(rsel * 4 + i) * 2 + 1]; }
        __syncthreads();
        const float mean = ts * (1.0f / D), var = tq * (1.0f / D) - mean * mean, rstd = 1.0f / sqrtf(fmaxf(var, 0.f) + LN_EPS);
        f32x4 y = (acc - mean) * rstd * lg + lb;
#pragma unroll
        for (int e = 0; e < 4; ++e) y[e] = silu_f(y[e]);
        u32x2 o; o.x = cvt_pk_bf16(y[0], y[1]); o.y = cvt_pk_bf16(y[2], y[3]);
        *(u32x2*)(Y2 + (size_t)r * D + c) = o;
        if (!smp && t >= SEQ - 30) { const u32x2 w = *(const u32x2*)(G + (size_t)r * D + c); *(f32x4*)(p.out + O_C31P + ((size_t)b * 30 + (t - (SEQ - 30))) * D + c) = (f32x4){bf_lo(w.x), bf_hi(w.x), bf_lo(w.y), bf_hi(w.y)}; }
        if (smp) { const u32x2 w = *(const u32x2*)(G + (size_t)r * D + c); *(f32x4*)(p.out + O_C31S + ((size_t)b * 30 + 22 + t) * D + c) = (f32x4){bf_lo(w.x), bf_hi(w.x), bf_lo(w.y), bf_hi(w.y)};
            for (int j = t; j < 22; j += 8) *(f32x4*)(p.out + O_C31S + ((size_t)b * 30 + j) * D + c) = *(const f32x4*)(st + ((size_t)b * 30 + 8 + j) * D + c); }
    }
}

__device__ __forceinline__ void a2_phase(const Params& p, LAS unsigned char* lds, const int tid, const int bid, const int NG) {
    const bf16_t* UV = (const bf16_t*)(p.ws + W_BIG); bf16_t* Y2 = (bf16_t*)(p.ws + W_Y2);
    const float* lng = p.in[I_ALNG]; const float* lnb = p.in[I_ALNB]; const float* ws_ = p.in[I_AWS]; const float* bs = p.in[I_ABS];
    const int wave = tid >> 6, lane = tid & 63, fr = lane & 15, fq = lane >> 4;
    LAS f32x2* stat = (LAS f32x2*)lds;
    LAS unsigned char* Wl = lds + 1024;
    LAS unsigned char* VT = lds + 1024 + 128 * 272;
    for (int item = bid; item < 512 + NDB; item += NG) {
        if (item < 512) {
            const int cidx = item >> 2, g = item & 3, row0 = cidx * 128;
            for (int i = 0; i < 16; ++i) { const int row = wave * 16 + i; const bf16_t* vr = UV + (size_t)(row0 + row) * 2048 + 1024 + lane * 16;
                float a[8], b[8]; unpack8(*(const u32x4*)vr, a); unpack8(*(const u32x4*)(vr + 8), b);
                float s = 0.f;
#pragma unroll
                for (int e = 0; e < 8; ++e) s += a[e] + b[e];
                const float mean = wave_sum(s) * (1.0f / D); float q = 0.f;
#pragma unroll
                for (int e = 0; e < 8; ++e) { const float da = a[e] - mean, db = b[e] - mean; q += da * da + db * db; }
                const float rstd = 1.0f / sqrtf(wave_sum(q) * (1.0f / D) + LN_EPS);
                if (lane == 0) stat[row] = (f32x2){mean, rstd}; }
#pragma unroll
            for (int i = 0; i < 8; ++i) { const int idx = tid + 512 * i, t = idx >> 5, s4 = (idx & 31) * 4; f32x4 w = *(const f32x4*)(ws_ + (size_t)g * 16384 + t * 128 + s4);
#pragma unroll
                for (int e = 0; e < 4; ++e) if (s4 + e > t) w[e] = 0.f;
                u32x2 o; o.x = cvt_pk_bf16(w[0], w[1]); o.y = cvt_pk_bf16(w[2], w[3]); *(LAS u32x2*)(Wl + t * 272 + s4 * 2) = o; }
            __syncthreads();
            const bool lastc = (cidx & 15) == 15;
            for (int itc = 0; itc < 4; ++itc) { const int chgrp = wave * 4 + itc, ch0 = g * 256 + chgrp * 8, s0 = 2 * lane;
                float a[8], b[8], gg[8], bb[8]; unpack8(*(const u32x4*)(UV + (size_t)(row0 + s0) * 2048 + 1024 + ch0), a); unpack8(*(const u32x4*)(UV + (size_t)(row0 + s0 + 1) * 2048 + 1024 + ch0), b);
                load8f(lng + ch0, gg); load8f(lnb + ch0, bb);
                const f32x2 sa = stat[s0], sb = stat[s0 + 1];
#pragma unroll
                for (int e = 0; e < 8; ++e) { a[e] = (a[e] - sa.x) * sa.y * gg[e] + bb[e]; b[e] = (b[e] - sb.x) * sb.y * gg[e] + bb[e]; }
                if (lastc) { float* o = p.out + O_VP + ((size_t)(cidx >> 4) * 128 + s0) * D + ch0; store8f(o, a); store8f(o + D, b); }
#pragma unroll
                for (int e = 0; e < 8; ++e) *(LAS unsigned*)(VT + (chgrp * 8 + e) * 272 + lane * 4) = cvt_pk_bf16(a[e], b[e]); }
            __syncthreads();
            f32x4 acc[2][8];
#pragma unroll
            for (int ct = 0; ct < 2; ++ct)
#pragma unroll
                for (int tt = 0; tt < 8; ++tt) acc[ct][tt] = (f32x4){0.f, 0.f, 0.f, 0.f};
#pragma unroll
            for (int ks = 0; ks < 4; ++ks) {
                bf16x8 xf[2];
#pragma unroll
                for (int ct = 0; ct < 2; ++ct) xf[ct] = *(const LAS bf16x8*)(VT + (wave * 32 + ct * 16 + fr) * 272 + (ks * 32 + fq * 8) * 2);
#pragma unroll
                for (int tt = 0; tt < 8; ++tt) if (16 * tt + 15 >= 32 * ks) {
                    const bf16x8 yf = *(const LAS bf16x8*)(Wl + (tt * 16 + fr) * 272 + (ks * 32 + fq * 8) * 2);
#pragma unroll
                    for (int ct = 0; ct < 2; ++ct) acc[ct][tt] = __builtin_amdgcn_mfma_f32_16x16x32_bf16(xf[ct], yf, acc[ct][tt], 0, 0, 0); }
            }
#pragma unroll
            for (int tt = 0; tt < 8; ++tt) { const int t = tt * 16 + fr; const float bsv = bs[g * 128 + t];
#pragma unroll
                for (int ct = 0; ct < 2; ++ct) { const int ch = g * 256 + wave * 32 + ct * 16 + 4 * fq; const u32x2 uw = *(const u32x2*)(UV + (size_t)(row0 + t) * 2048 + ch);
                    const f32x4 sv = acc[ct][tt] + bsv; u32x2 o; o.x = cvt_pk_bf16(bf_lo(uw.x) * sv[0], bf_hi(uw.x) * sv[1]); o.y = cvt_pk_bf16(bf_lo(uw.y) * sv[2], bf_hi(uw.y) * sv[3]);
                    *(u32x2*)(Y2 + (size_t)(row0 + t) * D + ch) = o; } }
            __syncthreads();
        } else {
            const int b = item - 512, r0 = NPR + b * 8;
            { const bf16_t* vr = UV + (size_t)(r0 + wave) * 2048 + 1024 + lane * 16;
                float a[8], bq[8]; unpack8(*(const u32x4*)vr, a); unpack8(*(const u32x4*)(vr + 8), bq);
                float s = 0.f;
#pragma unroll
                for (int e = 0; e < 8; ++e) s += a[e] + bq[e];
                const float mean = wave_sum(s) * (1.0f / D); float q = 0.f;
#pragma unroll
                for (int e = 0; e < 8; ++e) { const float da = a[e] - mean, db = bq[e] - mean; q += da * da + db * db; }
                const float rstd = 1.0f / sqrtf(wave_sum(q) * (1.0f / D) + LN_EPS);
                if (lane == 0) stat[wave] = (f32x2){mean, rstd}; }
            __syncthreads();
            const int c = tid * 2, g = c >> 8; const float g0 = lng[c], g1 = lng[c + 1], bb0 = lnb[c], bb1 = lnb[c + 1];
            float vn0[8], vn1[8];
#pragma unroll
            for (int t = 0; t < 8; ++t) { const unsigned w = *(const unsigned*)(UV + (size_t)(r0 + t) * 2048 + 1024 + c); const f32x2 sa = stat[t];
                vn0[t] = (bf_lo(w) - sa.x) * sa.y * g0 + bb0; vn1[t] = (bf_hi(w) - sa.x) * sa.y * g1 + bb1;
                *(f32x2*)(p.out + O_VS + ((size_t)b * 8 + t) * D + c) = (f32x2){vn0[t], vn1[t]}; }
#pragma unroll
            for (int t = 0; t < 8; ++t) { float s0 = bs[g * 128 + t], s1 = s0;
#pragma unroll
                for (int s = 0; s < 8; ++s) if (s <= t) { const float w = ws_[(size_t)g * 16384 + t * 128 + s]; s0 += w * vn0[s]; s1 += w * vn1[s]; }
                const unsigned uw = *(const unsigned*)(UV + (size_t)(r0 + t) * 2048 + c);
                *(unsigned*)(Y2 + (size_t)(r0 + t) * D + c) = cvt_pk_bf16(bf_lo(uw) * s0, bf_hi(uw) * s1); }
            __syncthreads();
        }
    }
}

constexpr int LDS_BYTES = pg8::STAGE_BYTES;
constexpr int NPHASE = 3 + 4 * 10;

__global__ void __launch_bounds__(512, 2) mega(Params p, int ph_lo, int ph_hi) {
    extern __shared__ __attribute__((aligned(16))) unsigned char smem[];
    LAS unsigned char* lds = (LAS unsigned char*)smem;
    bool first = true;
    for (int ph = ph_lo; ph < ph_hi; ++ph) {
        int tid = threadIdx.x, bid = blockIdx.x, G = gridDim.x; unsigned char* ws = p.ws;
        asm volatile("" : "+v"(tid)); asm volatile("" : "+s"(bid), "+s"(G), "+s"(ws));
        const float* MOD = (const float*)(ws + W_MOD);
        float* X = (float*)(ws + W_X); float* Z = (float*)(ws + W_Z);
        bf16_t* H = (bf16_t*)(ws + W_H); bf16_t* BIG = (bf16_t*)(ws + W_BIG); bf16_t* Y2 = (bf16_t*)(ws + W_Y2);
        int kind, l = 0, sp = 0;
        if (ph < 3) kind = ph;
        else { l = (ph - 3) / 10; sp = (ph - 3) % 10;
            if (sp == 0 || sp == 7) kind = 3;
            else if (sp == 1 || sp == 8) kind = 4;
            else if (sp == 2 || sp == 6 || sp == 9) kind = 5;
            else if (sp == 3) kind = l == 0 ? 6 : l == 1 ? 8 : l == 2 ? 10 : 12;
            else if (sp == 4) kind = l == 0 ? 7 : l == 1 ? 9 : l == 2 ? 11 : 4;
            else kind = l == 3 ? 13 : 4; }
        if (kind == 13) continue;
        if (!first) {
#if !MULTI_LAUNCH
            cg::this_grid().sync();
#endif
        }
        first = false;
        const int sub = sp < 3 ? 0 : (sp < 7 ? 1 : 2);
        const float* modls = MOD + (size_t)l * 9216 + (size_t)sub * 3072;
        pg8::StaticOrder S;
        if (kind == 0) p0_phase(p, lds, tid, bid, G);
        else if (kind == 1) { S.init(256, MODW, G, bid);
            pg8::Gemm g{(const bf16_t*)(ws + W_SC), (const bf16_t*)(ws + W_ADA), D, D, D, 0};
            pg8::EpiF32 E{(float*)(ws + W_MOD), MODW, p.in[I_ADAB]};
            pg8::gemm_phase(lds, g, S, E, tid); }
        else if (kind == 2) ln_phase<false>(p, nullptr, X, H, nullptr, nullptr, MOD, tid, bid, G);
        else if (kind == 3) { S.init(MROWS, 2 * DFF, G, bid);
            const int fi = l * 2 + (sp == 0 ? 0 : 1);
            pg8::Gemm g{H, (const bf16_t*)(ws + W_FIN) + (size_t)fi * 5632 * 1024, D, D, D, 0};
            pg8::EpiPair<0> E{BIG, DFF, nullptr, 0};
            pg8::gemm_phase(lds, g, S, E, tid); }
        else if (kind == 4) {
            pg8::Gemm g; pg8::EpiRes E{X, Z, modls + 2 * D, nullptr, nullptr, 1.0f};
            if (sp == 1 || sp == 8) { const int fi = l * 2 + (sp == 1 ? 0 : 1); g = pg8::Gemm{BIG, (const bf16_t*)(ws + W_FOUT) + (size_t)fi * 1024 * 2816, DFF, DFF, DFF, 0}; E.coef = 0.5f; }
            else if (l == 0) g = pg8::Gemm{Y2, (const bf16_t*)(ws + W_AOUT), D, D, D, 0};
            else if (l == 1) g = pg8::Gemm{Y2, (const bf16_t*)(ws + W_BOUT), D, D, D, 0};
            else if (l == 2) { g = pg8::Gemm{Y2, (const bf16_t*)(ws + W_CPW2), D, D, D, 0}; E.bias = p.in[I_CBPW2]; }
            else { g = pg8::Gemm{Y2, (const bf16_t*)(ws + W_DG), D, 256, 256, 256}; E.bias = p.in[I_DBG]; E.cscale = p.in[I_DSC]; }
            S.init(MROWS, D, G, bid);
            pg8::gemm_phase(lds, g, S, E, tid); }
        else if (kind == 5) {
            const int li = l * 3 + sub; const float* lg = p.in[I_LNG] + (size_t)li * D; const float* lb = p.in[I_LNB] + (size_t)li * D;
            if (l == 3 && sp == 9) ln_phase<true>(p, Z, p.out, nullptr, lg, lb, nullptr, tid, bid, G);
            else { const float* nm = sp == 9 ? MOD + (size_t)(l + 1) * 9216 : MOD + (size_t)l * 9216 + (size_t)(sub + 1) * 3072; ln_phase<true>(p, Z, X, H, lg, lb, nm, tid, bid, G); } }
        else if (kind == 6) { S.init(MROWS, 2048, G, bid);
            pg8::Gemm g{H, (const bf16_t*)(ws + W_AIN), D, D, D, 0}; pg8::EpiBf16<1> E{BIG, 2048, p.in[I_ABIN]};
            pg8::gemm_phase(lds, g, S, E, tid); }
        else if (kind == 7) a2_phase(p, lds, tid, bid, G);
        else if (kind == 8) { S.init(MROWS, 3072, G, bid);
            pg8::Gemm g{H, (const bf16_t*)(ws + W_BIN), D, D, D, 0}; pg8::EpiBf16<0> E{BIG, 3072, nullptr};
            pg8::gemm_phase(lds, g, S, E, tid); }
        else if (kind == 9) b2_phase(p, tid, bid, G);
        else if (kind == 10) { S.init(MROWS, 2048, G, bid);
            pg8::Gemm g{H, (const bf16_t*)(ws + W_CPW1), D, D, D, 0}; pg8::EpiPair<1> E{BIG, D, p.in[I_CBPW1], D};
            pg8::gemm_phase(lds, g, S, E, tid); }
        else if (kind == 11) c2_phase(p, lds, tid, bid, G);
        else if (kind == 12) d1_phase(p, tid, bid, G);
#if MULTI_LAUNCH
        __syncthreads();
#endif
    }
}

extern "C" void kernel_launch(void* const* d_in, const int* in_sizes, int n_in, void* d_out, int out_size, void* d_ws, size_t ws_size, hipStream_t stream) {
    static int grid = 0;
    if (grid == 0) {
        if (n_in != N_IN || (size_t)out_size != O_END || ws_size < W_END) { fprintf(stderr, "kernel_launch: unexpected shapes (n_in %d, out %d, ws %zu, need %zu)\n", n_in, out_size, ws_size, (size_t)W_END); grid = -1; return; }
        if (hipFuncSetAttribute((const void*)mega, hipFuncAttributeMaxDynamicSharedMemorySize, LDS_BYTES) != hipSuccess) { fprintf(stderr, "kernel_launch: hipFuncSetAttribute failed\n"); grid = -1; return; }
        int dev = 0, cus = 0, per_cu = 0;
        hipGetDevice(&dev); hipDeviceGetAttribute(&cus, hipDeviceAttributeMultiprocessorCount, dev);
        hipOccupancyMaxActiveBlocksPerMultiprocessor(&per_cu, (const void*)mega, 512, LDS_BYTES);
        (void)hipGetLastError();
        if (per_cu < 1) fprintf(stderr, "kernel_launch: occupancy query says %d blocks per CU\n", per_cu);
        grid = cus;
    }
    if (grid < 0) return;
    Params p{};
    for (int i = 0; i < N_IN; ++i) p.in[i] = (const float*)d_in[i];
    p.out = (float*)d_out; p.ws = (unsigned char*)d_ws;
#if MULTI_LAUNCH
    for (int ph = 0; ph < NPHASE; ++ph) hipLaunchKernelGGL(mega, dim3(grid), dim3(512), LDS_BYTES, stream, p, ph, ph + 1);
#else
    int lo = 0, hi = NPHASE;
    void* args[] = {&p, &lo, &hi};
    hipError_t e = hipLaunchCooperativeKernel((const void*)mega, dim3(grid), dim3(512), args, LDS_BYTES, stream);
    if (e != hipSuccess) fprintf(stderr, "cooperative launch failed: %s (grid %d)\n", hipGetErrorString(e), grid);
#endif
}
```
